# Optimizing an MI355X kernel written in HIP

```python
import math
import jax, jax.numpy as jnp
from jax import lax
import numpy as np


D_MODEL = 1024
BATCH = 16
SEQ = 2048
DEPTH = 2
DEC_BATCH = 16
DEC_SEQ = 16
PAST_LEN = 4096

CHUNK = 64
N_A = max(1, DEPTH // 2)
N_B = DEPTH - N_A
EPS = 1e-6

D_FF = 2816
PLE_DIM = 256

SSM_EXPAND = 2
D_INNER = SSM_EXPAND * D_MODEL
SSM_HEAD_DIM = 64
SSM_HEADS = D_INNER // SSM_HEAD_DIM
SSM_GROUPS = 4
SSM_HPG = SSM_HEADS // SSM_GROUPS
D_STATE = 128
CONV_W = 4
GN = SSM_GROUPS * D_STATE
CONV_DIM = D_INNER + 2 * GN
IN_A = D_INNER + CONV_DIM + SSM_HEADS
SSD_CHUNK = CHUNK

MLA_HEADS = 16
Q_LORA = 512
KV_LORA = 256
QK_NOPE = 64
QK_ROPE = 32
V_HEAD = 64
ROPE_BASE = 10000.0
ATTN_SCALE = (QK_NOPE + QK_ROPE) ** -0.5
Q_BLOCK = 128

kernel_name = 'yoco_ssd_mla_macaron_stream_step'


def rmsnorm(x, g):
    xf = x.astype(jnp.float32)
    y = xf * lax.rsqrt(jnp.mean(xf * xf, axis=-1, keepdims=True) + EPS)
    return (y * g.astype(jnp.float32)).astype(x.dtype)


def swiglu(u, wg, wu, wd):
    return (jax.nn.silu(u @ wg) * (u @ wu)) @ wd


def rope(x, pos):
    half = QK_ROPE // 2
    inv = ROPE_BASE ** (-jnp.arange(half, dtype=jnp.float32) / half)
    ang = pos.astype(jnp.float32)[:, None] * inv[None, :]
    shape = (pos.shape[0],) + (1,) * (x.ndim - 3) + (half,)
    cos = jnp.cos(ang).reshape(shape)
    sin = jnp.sin(ang).reshape(shape)
    xf = x.astype(jnp.float32)
    x1, x2 = xf[..., :half], xf[..., half:]
    return jnp.concatenate([x1 * cos - x2 * sin, x1 * sin + x2 * cos], axis=-1).astype(x.dtype)


def causal_conv(u, buf, w, b):
    T = u.shape[1]
    up = jnp.concatenate([buf.astype(u.dtype), u], axis=1)
    y = b + sum(up[:, k:k + T] * w[k] for k in range(CONV_W))
    return y, up[:, -(CONV_W - 1):]


def ssd_scan(x, dt, A, Bm, Cm, s0):
    b, T = x.shape[0], x.shape[1]
    L = min(SSD_CHUNK, T)
    nc = T // L
    f32 = jnp.float32
    xdt = (x.astype(f32) * dt[..., None]).reshape(b, nc, L, SSM_GROUPS, SSM_HPG, SSM_HEAD_DIM)
    a = (dt * A).reshape(b, nc, L, SSM_GROUPS, SSM_HPG)
    Bc = Bm.astype(f32).reshape(b, nc, L, SSM_GROUPS, D_STATE)
    Cc = Cm.astype(f32).reshape(b, nc, L, SSM_GROUPS, D_STATE)
    causal = jnp.tril(jnp.ones((L, L), dtype=bool))

    def step(s, inp):
        xk, ak, bk, ck = inp
        acs = jnp.cumsum(ak, axis=1)
        at = jnp.moveaxis(acs, 1, -1)
        seg = jnp.exp(jnp.where(causal, at[..., :, None] - at[..., None, :], -jnp.inf))
        cb = jnp.einsum('blgn,bsgn->bgls', ck, bk)
        y_diag = jnp.einsum('bghls,bsghp->blghp', cb[:, :, None] * seg, xk)
        y_off = jnp.einsum('blgn,bghpn->blghp', ck, s) * jnp.exp(acs)[..., None]
        to_end = jnp.exp(acs[:, -1:] - acs)
        s_new = s * jnp.exp(acs[:, -1])[..., None, None] + jnp.einsum('blgn,blghp->bghpn', bk, xk * to_end[..., None])
        return s_new, y_diag + y_off

    sw = lambda t: jnp.swapaxes(t, 0, 1)
    s_init = s0.astype(f32).reshape(b, SSM_GROUPS, SSM_HPG, SSM_HEAD_DIM, D_STATE)
    s_fin, y = lax.scan(step, s_init, (sw(xdt), sw(a), sw(Bc), sw(Cc)))
    y = sw(y).reshape(b, T, SSM_HEADS, SSM_HEAD_DIM)
    return y, s_fin.reshape(b, SSM_HEADS, SSM_HEAD_DIM, D_STATE)


def mamba2_mixer(u, conv_buf, ssm_state, w_in, conv_w, conv_b, dt_bias, A_log, Dp, norm_g, w_out):
    b, T, _ = u.shape
    zxbcdt = u @ w_in
    z = zxbcdt[..., :D_INNER]
    xbc = zxbcdt[..., D_INNER:D_INNER + CONV_DIM]
    dt_raw = zxbcdt[..., D_INNER + CONV_DIM:]
    xbc, new_buf = causal_conv(xbc, conv_buf, conv_w, conv_b)
    xbc = jax.nn.silu(xbc)
    xs = xbc[..., :D_INNER].reshape(b, T, SSM_HEADS, SSM_HEAD_DIM)
    Bm = xbc[..., D_INNER:D_INNER + GN].reshape(b, T, SSM_GROUPS, D_STATE)
    Cm = xbc[..., D_INNER + GN:].reshape(b, T, SSM_GROUPS, D_STATE)
    dt = jax.nn.softplus(dt_raw.astype(jnp.float32) + dt_bias.astype(jnp.float32))
    A = -jnp.exp(A_log.astype(jnp.float32))
    y, s_new = ssd_scan(xs, dt, A, Bm, Cm, ssm_state)
    y = y + Dp.astype(jnp.float32)[:, None] * xs.astype(jnp.float32)
    y = y.reshape(b, T, D_INNER).astype(u.dtype)
    y = rmsnorm(y * jax.nn.silu(z), norm_g)
    return y @ w_out, new_buf, s_new


def mla_kv_side(h, pos, ln_kv, w_kv_a, kv_norm, kr_norm):
    kv = rmsnorm(h, ln_kv) @ w_kv_a
    c_kv = rmsnorm(kv[..., :KV_LORA], kv_norm)
    k_rope = rope(rmsnorm(kv[..., KV_LORA:], kr_norm), pos)
    return c_kv, k_rope


def mla_expand(c_kv, w_kv_b, k_norm):
    b, S, _ = c_kv.shape
    kvb = (c_kv @ w_kv_b).reshape(b, S, MLA_HEADS, QK_NOPE + V_HEAD)
    k_nope = rmsnorm(kvb[..., :QK_NOPE], k_norm)
    return k_nope, kvb[..., QK_NOPE:]


def mla_queries(u, pos, w_dq, q_norm, w_q_b, qn_nope, qn_rope):
    b, T, _ = u.shape
    cq = rmsnorm(u @ w_dq, q_norm)
    q = (cq @ w_q_b).reshape(b, T, MLA_HEADS, QK_NOPE + QK_ROPE)
    q_nope = rmsnorm(q[..., :QK_NOPE], qn_nope)
    q_rope = rope(rmsnorm(q[..., QK_NOPE:], qn_rope), pos)
    return q_nope, q_rope


def attend(q_nope, q_rope, k_nope, k_rope, v, q_pos, k_pos):
    s = (jnp.einsum('bqhd,bkhd->bhqk', q_nope, k_nope)
         + jnp.einsum('bqhr,bkr->bhqk', q_rope, k_rope)).astype(jnp.float32) * ATTN_SCALE
    mask = (k_pos // CHUNK)[None, :] <= (q_pos // CHUNK)[:, None]
    s = jnp.where(mask[None, None], s, -jnp.inf)
    p = jax.nn.softmax(s, axis=-1).astype(v.dtype)
    return jnp.einsum('bhqk,bkhd->bqhd', p, v)


def attend_blocked(q_nope, q_rope, k_nope, k_rope, v, pos):
    b, T = q_nope.shape[0], q_nope.shape[1]
    nb = T // Q_BLOCK
    qn = jnp.swapaxes(q_nope.reshape(b, nb, Q_BLOCK, MLA_HEADS, QK_NOPE), 0, 1)
    qr = jnp.swapaxes(q_rope.reshape(b, nb, Q_BLOCK, MLA_HEADS, QK_ROPE), 0, 1)
    qp = pos.reshape(nb, Q_BLOCK)
    out = lax.map(lambda a: attend(a[0], a[1], k_nope, k_rope, v, a[2], pos), (qn, qr, qp))
    return jnp.swapaxes(out, 0, 1).reshape(b, T, MLA_HEADS, V_HEAD)


def setup_inputs(seed: int = 0) -> dict:
    key = jax.random.key(seed)
    ks = iter(jax.random.split(key, 64))
    f32 = jnp.float32

    def nrm(shape, fan_in):
        return jax.random.normal(next(ks), shape, f32) * fan_in ** -0.5

    def gain(shape):
        return 1.0 + 0.05 * jax.random.normal(next(ks), shape, f32)

    x_prompt = jax.random.normal(next(ks), (BATCH, SEQ, D_MODEL), f32)
    x_sample = jax.random.normal(next(ks), (DEC_BATCH, DEC_SEQ, D_MODEL), f32)
    p_prompt = jax.random.normal(next(ks), (DEPTH, BATCH, SEQ, PLE_DIM), f32)
    p_sample = jax.random.normal(next(ks), (DEPTH, DEC_BATCH, DEC_SEQ, PLE_DIM), f32)
    state_conv = jax.random.normal(next(ks), (N_A, DEC_BATCH, CONV_W - 1, CONV_DIM), f32)
    state_ssm = 0.1 * jax.random.normal(next(ks), (N_A, DEC_BATCH, SSM_HEADS, SSM_HEAD_DIM, D_STATE), f32)
    cache_kv_latent = jax.random.normal(next(ks), (DEC_BATCH, PAST_LEN, KV_LORA), f32)
    cache_k_rope = jax.random.normal(next(ks), (DEC_BATCH, PAST_LEN, QK_ROPE), f32)

    ln_ffn1 = gain((DEPTH, D_MODEL))
    w1_gate = nrm((DEPTH, D_MODEL, D_FF), D_MODEL)
    w1_up = nrm((DEPTH, D_MODEL, D_FF), D_MODEL)
    w1_down = nrm((DEPTH, D_FF, D_MODEL), D_FF)
    ln_mix = gain((DEPTH, D_MODEL))
    ln_ffn2 = gain((DEPTH, D_MODEL))
    w2_gate = nrm((DEPTH, D_MODEL, D_FF), D_MODEL)
    w2_up = nrm((DEPTH, D_MODEL, D_FF), D_MODEL)
    w2_down = nrm((DEPTH, D_FF, D_MODEL), D_FF)
    ln_ple = gain((DEPTH, D_MODEL))
    w_ple_in = nrm((DEPTH, PLE_DIM, D_MODEL), PLE_DIM)
    w_ple_gate = nrm((DEPTH, D_MODEL, D_MODEL), D_MODEL)

    a_in_proj = nrm((N_A, D_MODEL, IN_A), D_MODEL)
    a_conv_w = nrm((N_A, CONV_W, CONV_DIM), CONV_W)
    a_conv_b = 0.01 * jax.random.normal(next(ks), (N_A, CONV_DIM), f32)
    dt0 = jnp.exp(jax.random.uniform(next(ks), (N_A, SSM_HEADS), f32, math.log(1e-3), math.log(1e-1)))
    a_dt_bias = dt0 + jnp.log(-jnp.expm1(-dt0))
    a_A_log = jnp.log(jax.random.uniform(next(ks), (N_A, SSM_HEADS), f32, 1.0, 16.0))
    a_D = 1.0 + 0.1 * jax.random.normal(next(ks), (N_A, SSM_HEADS), f32)
    a_norm = gain((N_A, D_INNER))
    a_out_proj = nrm((N_A, D_INNER, D_MODEL), D_INNER)

    ln_kv = gain((D_MODEL,))
    w_kv_a = nrm((D_MODEL, KV_LORA + QK_ROPE), D_MODEL)
    kv_norm = gain((KV_LORA,))
    kr_norm = gain((QK_ROPE,))
    w_kv_b = nrm((KV_LORA, MLA_HEADS * (QK_NOPE + V_HEAD)), KV_LORA)
    k_norm = gain((QK_NOPE,))

    b_w_dq = nrm((N_B, D_MODEL, Q_LORA), D_MODEL)
    b_q_norm = gain((N_B, Q_LORA))
    b_w_q_b = nrm((N_B, Q_LORA, MLA_HEADS * (QK_NOPE + QK_ROPE)), Q_LORA)
    b_qn_nope = gain((N_B, QK_NOPE))
    b_qn_rope = gain((N_B, QK_ROPE))
    b_w_o = nrm((N_B, MLA_HEADS * V_HEAD, D_MODEL), MLA_HEADS * V_HEAD)

    return {'x_prompt': x_prompt, 'x_sample': x_sample, 'p_prompt': p_prompt, 'p_sample': p_sample,
            'state_conv': state_conv, 'state_ssm': state_ssm,
            'cache_kv_latent': cache_kv_latent, 'cache_k_rope': cache_k_rope,
            'ln_ffn1': ln_ffn1, 'w1_gate': w1_gate, 'w1_up': w1_up, 'w1_down': w1_down,
            'ln_mix': ln_mix, 'ln_ffn2': ln_ffn2, 'w2_gate': w2_gate, 'w2_up': w2_up, 'w2_down': w2_down,
            'ln_ple': ln_ple, 'w_ple_in': w_ple_in, 'w_ple_gate': w_ple_gate,
            'a_in_proj': a_in_proj, 'a_conv_w': a_conv_w, 'a_conv_b': a_conv_b, 'a_dt_bias': a_dt_bias,
            'a_A_log': a_A_log, 'a_D': a_D, 'a_norm': a_norm, 'a_out_proj': a_out_proj,
            'ln_kv': ln_kv, 'w_kv_a': w_kv_a, 'kv_norm': kv_norm, 'kr_norm': kr_norm,
            'w_kv_b': w_kv_b, 'k_norm': k_norm,
            'b_w_dq': b_w_dq, 'b_q_norm': b_q_norm, 'b_w_q_b': b_w_q_b,
            'b_qn_nope': b_qn_nope, 'b_qn_rope': b_qn_rope, 'b_w_o': b_w_o}


def reference(x_prompt, x_sample, p_prompt, p_sample, state_conv, state_ssm, cache_kv_latent, cache_k_rope,
              ln_ffn1, w1_gate, w1_up, w1_down, ln_mix, ln_ffn2, w2_gate, w2_up, w2_down,
              ln_ple, w_ple_in, w_ple_gate,
              a_in_proj, a_conv_w, a_conv_b, a_dt_bias, a_A_log, a_D, a_norm, a_out_proj,
              ln_kv, w_kv_a, kv_norm, kr_norm, w_kv_b, k_norm,
              b_w_dq, b_q_norm, b_w_q_b, b_qn_nope, b_qn_rope, b_w_o):

    def run_group(x, p, pos, conv_in, ssm_in, past_ckv, past_kr):
        b, T = x.shape[0], x.shape[1]
        h = x
        convs, ssms = [], []
        ckv_new = kr_new = k_nope = v = k_rope_all = k_pos = None
        for i in range(DEPTH):
            h = h + 0.5 * swiglu(rmsnorm(h, ln_ffn1[i]), w1_gate[i], w1_up[i], w1_down[i])
            u = rmsnorm(h, ln_mix[i])
            if i < N_A:
                mix, cbuf, sst = mamba2_mixer(u, conv_in[i], ssm_in[i], a_in_proj[i], a_conv_w[i], a_conv_b[i],
                                              a_dt_bias[i], a_A_log[i], a_D[i], a_norm[i], a_out_proj[i])
                convs.append(cbuf)
                ssms.append(sst)
            else:
                j = i - N_A
                q_nope, q_rope = mla_queries(u, pos, b_w_dq[j], b_q_norm[j], b_w_q_b[j], b_qn_nope[j], b_qn_rope[j])
                if past_ckv is None:
                    o = attend_blocked(q_nope, q_rope, k_nope, k_rope_all, v, pos)
                else:
                    o = attend(q_nope, q_rope, k_nope, k_rope_all, v, pos, k_pos)
                mix = o.reshape(b, T, MLA_HEADS * V_HEAD) @ b_w_o[j]
            h = h + mix
            h = h + 0.5 * swiglu(rmsnorm(h, ln_ffn2[i]), w2_gate[i], w2_up[i], w2_down[i])
            h = h + (p[i] @ w_ple_in[i]) * jax.nn.sigmoid(rmsnorm(h, ln_ple[i]) @ w_ple_gate[i])
            if i == N_A - 1:
                ckv_new, kr_new = mla_kv_side(h, pos, ln_kv, w_kv_a, kv_norm, kr_norm)
                if past_ckv is None:
                    ckv_all, k_rope_all, k_pos = ckv_new, kr_new, pos
                else:
                    ckv_all = jnp.concatenate([past_ckv.astype(ckv_new.dtype), ckv_new], axis=1)
                    k_rope_all = jnp.concatenate([past_kr.astype(kr_new.dtype), kr_new], axis=1)
                    k_pos = jnp.arange(past_ckv.shape[1] + T, dtype=jnp.int32)
                k_nope, v = mla_expand(ckv_all, w_kv_b, k_norm)
        return h, jnp.stack(convs), jnp.stack(ssms), ckv_new, kr_new

    pos_p = jnp.arange(x_prompt.shape[1], dtype=jnp.int32)
    conv0 = jnp.zeros((N_A, x_prompt.shape[0], CONV_W - 1, CONV_DIM), x_prompt.dtype)
    ssm0 = jnp.zeros((N_A, x_prompt.shape[0], SSM_HEADS, SSM_HEAD_DIM, D_STATE), jnp.float32)
    y_prompt, conv_p, ssm_p, kv_p, kr_p = run_group(x_prompt, p_prompt, pos_p, conv0, ssm0, None, None)

    past_len = cache_kv_latent.shape[1]
    pos_s = past_len + jnp.arange(x_sample.shape[1], dtype=jnp.int32)
    y_sample, conv_s, ssm_s, kv_s, kr_s = run_group(x_sample, p_sample, pos_s, state_conv, state_ssm,
                                                    cache_kv_latent, cache_k_rope)

    return (y_prompt, y_sample, conv_p, ssm_p, kv_p, kr_p, conv_s, ssm_s, kv_s, kr_s)
```

```cpp
#include <hip/hip_runtime.h>
#include <hip/hip_bf16.h>
#include <hip/hip_cooperative_groups.h>
#include <cstdio>
namespace cg = cooperative_groups;

typedef unsigned short u16;
using bf16x8 = __attribute__((ext_vector_type(8))) short;
using s16x4 = __attribute__((ext_vector_type(4))) short;
using f32x4 = __attribute__((ext_vector_type(4))) float;
using f32x16 = __attribute__((ext_vector_type(16))) float;
typedef unsigned u32x4 __attribute__((ext_vector_type(4)));
typedef unsigned u32x2 __attribute__((ext_vector_type(2)));
__device__ __forceinline__ u32x4 mk4(unsigned a, unsigned b, unsigned c, unsigned d) { u32x4 r = {a, b, c, d}; return r; }
#define DI __device__ __forceinline__
#define MFMA32(a, b, c) __builtin_amdgcn_mfma_f32_32x32x16_bf16((a), (b), (c), 0, 0, 0)

constexpr int MP = 32768, MS = 256, MT = 33024, DM = 1024, DFF = 2816;
constexpr int BATCH = 16, SEQ = 2048, DSEQ = 16, PAST = 4096, SKV = 4112;
constexpr int DIN = 2048, CONVD = 3072, NINA = 5152, NINP = 5376;
constexpr float EPS = 1e-6f;
constexpr int NTHR = 512;
constexpr int LDS_BYTES = 147456;

constexpr size_t O_Y = 0;
constexpr size_t O_CONVP = 33816576, O_SSMP = 33964032, O_KVP = 38158336, O_KRP = 46546944;
constexpr size_t O_CONVS = 47595520, O_SSMS = 47742976, O_KVS = 51937280, O_KRS = 52002816;

constexpr size_t W_GU1_1 = 0;
constexpr size_t W_D1_1 = W_GU1_1 + 12582912;
constexpr size_t W_GU2_1 = W_D1_1 + 5767168;
constexpr size_t W_D2_1 = W_GU2_1 + 11534336;
constexpr size_t W_PI_1 = W_D2_1 + 5767168;
constexpr size_t W_PG_1 = W_PI_1 + 524288;
constexpr size_t W_KVB = W_PG_1 + 2097152;
constexpr size_t W_KVBS = W_KVB + 1048576;
constexpr size_t W_DQ = W_KVBS + 1048576;
constexpr size_t W_QB = W_DQ + 1048576;
constexpr size_t W_O = W_QB + 1572864;
constexpr size_t WS_HB = W_O + 2097152;
constexpr size_t WS_PB0 = WS_HB + 67633152;
constexpr size_t WS_SS = WS_PB0 + 16908288;
constexpr size_t WS_E = WS_SS + 2113536;
constexpr size_t W_GU1_0 = WS_E;
constexpr size_t W_D1_0 = W_GU1_0 + 11534336;
constexpr size_t W_GU2_0 = W_D1_0 + 5767168;
constexpr size_t W_D2_0 = W_GU2_0 + 11534336;
constexpr size_t W_PI_0 = W_D2_0 + 5767168;
constexpr size_t W_PG_0 = W_PI_0 + 524288;
constexpr size_t W_IN = W_PG_0 + 2097152;
constexpr size_t W_OUT = W_IN + 11010048;
constexpr size_t WS_R = W_OUT + 4194304;
constexpr size_t R_ACT = WS_R;
constexpr size_t R_PIN = WS_R;
constexpr size_t R_Z = WS_R;
constexpr size_t R_XBC = R_Z + 135266304;
constexpr size_t R_DT = R_XBC + 202899456;
constexpr size_t R_END0 = R_DT + 4227072;
constexpr size_t E_ACT = WS_E;
constexpr size_t E_KVRAW = WS_E + 185991168;
constexpr size_t E_CKVP = WS_E + 224034816;
constexpr size_t E_CKVS = WS_E + 240812032;
constexpr size_t E_KRP = WS_E + 274497536;
constexpr size_t E_KRS = WS_E + 276594688;
constexpr size_t E_CQ = WS_E;
constexpr size_t E_KN = WS_E + 33816576;
constexpr size_t E_VT = WS_E + 100925440;
constexpr size_t E_QRAW = WS_E + 280805376;
constexpr size_t E_O = WS_E + 168034304;
constexpr size_t E_PIN = WS_E + 185991168;
constexpr size_t E_PB1 = E_PIN + 67633152;
constexpr size_t E_END = E_QRAW + 101449728;
constexpr size_t WS_NEED = 536870912;
static_assert(R_END0 <= WS_NEED && E_END <= WS_NEED, "workspace overflow");

struct Params {
    const float* in[40];
    float* out;
    unsigned char* ws;
    int ph_lo, ph_hi;
};

extern __shared__ __attribute__((aligned(16))) unsigned char smem[];

DI u16 f2bf(float x) { unsigned u = __float_as_uint(x); u += 0x7fffu + ((u >> 16) & 1u); return (u16)(u >> 16); }
DI float bf2f(u16 h) { return __uint_as_float(((unsigned)h) << 16); }
typedef __bf16 bf2_t __attribute__((ext_vector_type(2)));
typedef float f2_t __attribute__((ext_vector_type(2)));
DI unsigned pack2(float a, float b) { f2_t v = {a, b}; bf2_t r = __builtin_convertvector(v, bf2_t); return __builtin_bit_cast(unsigned, r); }
DI float siluf(float x) { return x / (1.f + __expf(-x)); }
DI float sigmf(float x) { return 1.f / (1.f + __expf(-x)); }
DI float red16(float v) {
    v += __shfl_xor(v, 1); v += __shfl_xor(v, 2); v += __shfl_xor(v, 4); v += __shfl_xor(v, 8); return v;
}

struct TJob { const float* src; u16* dst; const float* gain; int K, N, mode, rowoff; };
DI int nmap(int mode, int n) {
    if (mode == 1) return (n >> 7) * 256 + (n & 127);
    if (mode == 2) return (n >> 7) * 256 + 128 + (n & 127);
    if (mode == 3) { int head = n >> 7, part = (n >> 6) & 1, idx = n & 63; return (head >> 1) * 256 + (idx >> 5) * 128 + ((head & 1) * 2 + part) * 32 + (idx & 31); }
    return n;
}
DI TJob get_tjob(const Params& P, int j) {
    TJob t; t.gain = nullptr; t.mode = 0; t.rowoff = 0;
    unsigned char* ws = P.ws;
    int i = 0, jj = j;
    if (j < 16) { i = j >> 3; jj = j & 7; }
    switch (jj) {
    case 0: t.src = P.in[9] + (size_t)i * DM * DFF; t.dst = (u16*)(ws + (i ? W_GU1_1 : W_GU1_0)); t.gain = P.in[8] + i * DM; t.K = DM; t.N = DFF; t.mode = 1; break;
    case 1: t.src = P.in[10] + (size_t)i * DM * DFF; t.dst = (u16*)(ws + (i ? W_GU1_1 : W_GU1_0)); t.gain = P.in[8] + i * DM; t.K = DM; t.N = DFF; t.mode = 2; break;
    case 2: t.src = P.in[11] + (size_t)i * DM * DFF; t.dst = (u16*)(ws + (i ? W_D1_1 : W_D1_0)); t.K = DFF; t.N = DM; break;
    case 3: t.src = P.in[14] + (size_t)i * DM * DFF; t.dst = (u16*)(ws + (i ? W_GU2_1 : W_GU2_0)); t.gain = P.in[13] + i * DM; t.K = DM; t.N = DFF; t.mode = 1; break;
    case 4: t.src = P.in[15] + (size_t)i * DM * DFF; t.dst = (u16*)(ws + (i ? W_GU2_1 : W_GU2_0)); t.gain = P.in[13] + i * DM; t.K = DM; t.N = DFF; t.mode = 2; break;
    case 5: t.src = P.in[16] + (size_t)i * DM * DFF; t.dst = (u16*)(ws + (i ? W_D2_1 : W_D2_0)); t.K = DFF; t.N = DM; break;
    case 6: t.src = P.in[18] + (size_t)i * 256 * DM; t.dst = (u16*)(ws + (i ? W_PI_1 : W_PI_0)); t.K = 256; t.N = DM; break;
    case 7: t.src = P.in[19] + (size_t)i * DM * DM; t.dst = (u16*)(ws + (i ? W_PG_1 : W_PG_0)); t.gain = P.in[17] + i * DM; t.K = DM; t.N = DM; break;
    case 16: t.src = P.in[20]; t.dst = (u16*)(ws + W_IN); t.gain = P.in[12]; t.K = DM; t.N = NINA; break;
    case 17: t.src = P.in[27]; t.dst = (u16*)(ws + W_OUT); t.gain = P.in[26]; t.K = DIN; t.N = DM; break;
    case 18: t.src = P.in[29]; t.dst = (u16*)(ws + W_GU1_1); t.gain = P.in[28]; t.K = DM; t.N = 288; t.rowoff = 5632; break;
    case 19: t.src = P.in[32]; t.dst = (u16*)(ws + W_KVB); t.K = 256; t.N = 2048; t.mode = 3; break;
    case 20: t.src = P.in[32]; t.dst = (u16*)(ws + W_KVBS); t.K = 256; t.N = 2048; break;
    case 21: t.src = P.in[34]; t.dst = (u16*)(ws + W_DQ); t.gain = P.in[12] + DM; t.K = DM; t.N = 512; break;
    case 22: t.src = P.in[36]; t.dst = (u16*)(ws + W_QB); t.gain = P.in[35]; t.K = 512; t.N = 1536; break;
    default: t.src = P.in[39]; t.dst = (u16*)(ws + W_O); t.K = DM; t.N = DM; break;
    }
    return t;
}
constexpr int NTJOBS = 24;

DI void pconv(const Params& P, int layer, u16* pb) {
    int tid = threadIdx.x; asm volatile("" : "+v"(tid));
    const size_t gt = (size_t)blockIdx.x * NTHR + tid, gs = (size_t)gridDim.x * NTHR;
    for (size_t i = gt; i < (size_t)MT * 64; i += gs) {
        const size_t row = i >> 6; const int c = (int)(i & 63) * 4;
        const float* src = row < MP ? P.in[2] + ((size_t)layer * MP + row) * 256 + c : P.in[3] + ((size_t)layer * MS + (row - MP)) * 256 + c;
        float4 v = *(const float4*)src;
        u32x2 o; o.x = pack2(v.x, v.y); o.y = pack2(v.z, v.w);
        *(u32x2*)(pb + row * 256 + c) = o;
    }
}
DI void prep_phase(const Params& P) {
    int tid = threadIdx.x; asm volatile("" : "+v"(tid));
    float* tile = (float*)smem;
    {
        int base = 0;
        for (int j = 0; j < NTJOBS; ++j) {
            TJob t = get_tjob(P, j);
            const int tk = t.K >> 6, tn = (t.N + 63) >> 6, nt = tk * tn;
            int first = (int)blockIdx.x - (base % (int)gridDim.x);
            if (first < 0) first += gridDim.x;
            for (int lt = first; lt < nt; lt += gridDim.x) {
                const int kt = lt % tk, ntile = lt / tk;
                const int k0 = kt << 6, n0 = ntile << 6;
                __syncthreads();
#pragma unroll
                for (int i = 0; i < 2; ++i) {
                    const int kk = (tid >> 4) + 32 * i, nn = (tid & 15) * 4;
                    float4 v = make_float4(0.f, 0.f, 0.f, 0.f);
                    if (n0 + nn < t.N) v = *(const float4*)(t.src + (size_t)(k0 + kk) * t.N + n0 + nn);
                    const float g = t.gain ? t.gain[k0 + kk] : 1.f;
                    tile[kk * 65 + nn + 0] = v.x * g; tile[kk * 65 + nn + 1] = v.y * g;
                    tile[kk * 65 + nn + 2] = v.z * g; tile[kk * 65 + nn + 3] = v.w * g;
                }
                __syncthreads();
                const int n = tid >> 3, kc = (tid & 7) * 8;
                if (n0 + n < t.N) {
                    u32x4 o;
                    o.x = pack2(tile[(kc + 0) * 65 + n], tile[(kc + 1) * 65 + n]);
                    o.y = pack2(tile[(kc + 2) * 65 + n], tile[(kc + 3) * 65 + n]);
                    o.z = pack2(tile[(kc + 4) * 65 + n], tile[(kc + 5) * 65 + n]);
                    o.w = pack2(tile[(kc + 6) * 65 + n], tile[(kc + 7) * 65 + n]);
                    *(u32x4*)(t.dst + (size_t)(t.rowoff + nmap(t.mode, n0 + n)) * t.K + k0 + kc) = o;
                }
            }
            base += nt;
        }
    }
    {
        const size_t gt = (size_t)blockIdx.x * NTHR + tid, gs = (size_t)gridDim.x * NTHR;
        u32x4 z4 = mk4(0, 0, 0, 0);
        u32x4* p1 = (u32x4*)(P.ws + W_IN + (size_t)NINA * DM * 2);
        u32x4* p2 = (u32x4*)(P.ws + W_GU1_1 + (size_t)5920 * DM * 2);
        for (size_t i = gt; i < 224 * 128; i += gs) { p1[i] = z4; p2[i] = z4; }
        u32x4* p3 = (u32x4*)(P.ws + WS_SS + (size_t)MT * 4);
        for (size_t i = gt; i < (size_t)15 * MT / 4; i += gs) p3[i] = z4;
    }
    {
        const int wave = tid >> 6, lane = tid & 63;
        u16* hb = (u16*)(P.ws + WS_HB);
        float* ss0 = (float*)(P.ws + WS_SS);
        for (int row = blockIdx.x * 8 + wave; row < MT; row += gridDim.x * 8) {
            const float* src = row < MP ? P.in[0] + (size_t)row * DM : P.in[1] + (size_t)(row - MP) * DM;
            float s = 0.f;
#pragma unroll
            for (int i = 0; i < 4; ++i) {
                const int c = (i * 64 + lane) * 4;
                float4 v = *(const float4*)(src + c);
                *(float4*)(P.out + (size_t)row * DM + c) = v;
                u32x2 o; o.x = pack2(v.x, v.y); o.y = pack2(v.z, v.w);
                *(u32x2*)(hb + (size_t)row * DM + c) = o;
                s += v.x * v.x + v.y * v.y + v.z * v.z + v.w * v.w;
            }
#pragma unroll
            for (int o = 32; o > 0; o >>= 1) s += __shfl_xor(s, o);
            if (lane == 0) ss0[row] = s;
        }
    }
    pconv(P, 0, (u16*)(P.ws + WS_PB0));
}

#define LAS __attribute__((address_space(3)))
constexpr int BM = 256, BK = 64, HALF = 128, HTB = HALF * BK * 2, NXCD = 8, WGM = 8;
DI int lds_byte(int r, int c) { const int st = (r >> 4) * 2 + (c >> 5), rr = r & 15, cc = c & 31, ob = rr * 64 + cc * 2; return st * 1024 + (ob ^ (((ob >> 9) & 1) << 5)); }
DI void stage_rc(int b, int& R, int& C) { const int st = b / 1024, sb = b % 1024, swz = sb ^ (((sb >> 9) & 1) << 5); R = (st >> 1) * 16 + swz / 64; C = (st & 1) * 32 + (swz % 64) / 2; }
struct Unit { int pm, pn; };
DI bool unit_next(int i, int nM, int nN, Unit& u) {
    const int nwg = nM * nN;
    const long L = (long)i * gridDim.x + blockIdx.x; if (L >= nwg) return false;
    int wgid = (int)L; { const int q = nwg / NXCD, r = nwg % NXCD, xcd = wgid % NXCD, off = wgid / NXCD; wgid = (xcd < r ? xcd * (q + 1) : r * (q + 1) + (xcd - r) * q) + off; }
    const int nig = WGM * nN, gid = wgid / nig, fm = gid * WGM, gsz = (nM - fm) < WGM ? (nM - fm) : WGM;
    u.pm = fm + ((wgid % nig) % gsz); u.pn = (wgid % nig) / gsz; return true;
}

template <class Epi>
DI void epi_big(const Epi& E, f32x4 (&acc)[2][2][4][2], const Unit& u, int wr, int wc, int fr, int fq) {
    if constexpr (Epi::CUSTOM) { E.custom(acc, u, wr, wc, fr, fq); return; }
#pragma unroll
    for (int ai = 0; ai < 2; ++ai)
#pragma unroll
        for (int m = 0; m < 4; ++m) {
            const int row = u.pm * BM + ai * HALF + wr * 64 + m * 16 + fr;
            const float rs = E.rowscale(row);
            float s = 0.f;
            if (Epi::DUAL) {
#pragma unroll
                for (int n = 0; n < 2; ++n) s += E.quad(row, u.pn * 128 + wc * 32 + n * 16 + fq * 4, acc[ai][0][m][n], acc[ai][1][m][n], rs);
            } else {
#pragma unroll
                for (int bj = 0; bj < 2; ++bj)
#pragma unroll
                    for (int n = 0; n < 2; ++n) s += E.quad(row, u.pn * BM + bj * HALF + wc * 32 + n * 16 + fq * 4, acc[ai][bj][m][n], acc[ai][bj][m][n], rs);
            }
            if (Epi::SS) { s += __shfl_xor(s, 16); s += __shfl_xor(s, 32); if (fq == 0) E.addss(row, s); }
            asm volatile("" ::: "memory");
        }
}

template <class Epi>
DI void gemm_big(const u16* __restrict__ Ag, const u16* __restrict__ Btg, int K, int nM, int nN, const Epi& E) {
    LAS unsigned char* lds = (LAS unsigned char*)smem;
    int tid = threadIdx.x; asm volatile("" : "+v"(tid));
    const int wid = __builtin_amdgcn_readfirstlane(tid >> 6), lane = tid & 63, wr = wid >> 2, wc = wid & 3, fr = lane & 15, fq = lane >> 4;
    const int nt = K / BK;
    unsigned voffA[2];
#pragma unroll
    for (int i = 0; i < 2; ++i) { int R, C; stage_rc(tid * 16 + i * 8192, R, C); voffA[i] = (unsigned)(R * K + C) * 2u; }
    const size_t kstep = (size_t)(BK * 2);
    const size_t hstep = (size_t)HALF * K * 2;
    const size_t tstep = 2 * hstep;
    const unsigned ldsw = (unsigned)wid * 1024u;
    const int aoff = lds_byte(wr * 64 + fr, fq * 8), boff = lds_byte(wc * 32 + fr, fq * 8);
#define PG8_SA(b, h) (((b) * 2 + (h)) * HTB)
#define PG8_SB(b, h) ((4 + (b) * 2 + (h)) * HTB)
#define PG8_STAGE(bufoff, gbase) do { _Pragma("unroll") for (int _i = 0; _i < 2; ++_i) \
        __builtin_amdgcn_global_load_lds((const unsigned*)((const char*)(gbase) + voffA[_i]), (LAS unsigned*)(lds + (bufoff) + ldsw + _i * 8192), 16, 0, 0); } while (0)
#define PG8_LDA(dst, b, h) do { _Pragma("unroll") for (int m = 0; m < 4; ++m) _Pragma("unroll") for (int k = 0; k < 2; ++k) dst[m][k] = *(const LAS bf16x8*)(lds + PG8_SA(b, h) + aoff + m * 2048 + k * 1024); } while (0)
#define PG8_LDB(dst, b, h) do { _Pragma("unroll") for (int n = 0; n < 2; ++n) _Pragma("unroll") for (int k = 0; k < 2; ++k) dst[n][k] = *(const LAS bf16x8*)(lds + PG8_SB(b, h) + boff + n * 2048 + k * 1024); } while (0)
#define PG8_MMA(ai, bj, At_, Bt_) do { __builtin_amdgcn_s_setprio(1); _Pragma("unroll") for (int m = 0; m < 4; ++m) _Pragma("unroll") for (int n = 0; n < 2; ++n) _Pragma("unroll") for (int k = 0; k < 2; ++k) \
        acc[ai][bj][m][n] = __builtin_amdgcn_mfma_f32_16x16x32_bf16(Bt_[n][k], At_[m][k], acc[ai][bj][m][n], 0, 0, 0); __builtin_amdgcn_s_setprio(0); } while (0)
#define PG8_WAIT_V(n) asm volatile("s_waitcnt vmcnt(" #n ")" ::: "memory")
#define PG8_WAIT_L(n) asm volatile("s_waitcnt lgkmcnt(" #n ")" ::: "memory")
#define PG8_BAR __builtin_amdgcn_s_barrier()
#define PG8_SCHED __builtin_amdgcn_sched_barrier(0)
    Unit cur, nxt; int ui = 0;
    if (!unit_next(0, nM, nN, cur)) return;
    f32x4 acc[2][2][4][2];
#pragma unroll
    for (int a = 0; a < 2; ++a)
#pragma unroll
        for (int b = 0; b < 2; ++b)
#pragma unroll
            for (int m = 0; m < 4; ++m)
#pragma unroll
                for (int n = 0; n < 2; ++n) acc[a][b][m][n] = (f32x4){0.f, 0.f, 0.f, 0.f};
    bf16x8 At[4][2], B0[2][2], B1[2][2];
    const char* cA = (const char*)Ag + (size_t)cur.pm * tstep; const char* cB = (const char*)Btg + (size_t)cur.pn * tstep;
    PG8_STAGE(PG8_SB(0, 0), cB); PG8_STAGE(PG8_SA(0, 0), cA); PG8_STAGE(PG8_SB(0, 1), cB + hstep); PG8_STAGE(PG8_SA(0, 1), cA + hstep);
    if (wr == 1) PG8_BAR;
    PG8_WAIT_V(4); PG8_BAR;
    PG8_STAGE(PG8_SB(1, 0), cB + kstep); PG8_STAGE(PG8_SA(1, 0), cA + kstep); PG8_STAGE(PG8_SB(1, 1), cB + hstep + kstep);
    PG8_WAIT_V(6); PG8_BAR;
    for (;;) {
        const bool has_next = unit_next(ui + 1, nM, nN, nxt);
        const char* nA = has_next ? (const char*)Ag + (size_t)nxt.pm * tstep : cA; const char* nB = has_next ? (const char*)Btg + (size_t)nxt.pn * tstep : cB;
        for (int t = 0; t < nt; t += 2) {
            const bool last = (t == nt - 2);
            const char* a1 = cA + (size_t)(t + 1) * kstep;
            const char* a2 = last ? nA : cA + (size_t)(t + 2) * kstep; const char* b2 = last ? nB : cB + (size_t)(t + 2) * kstep;
            const char* a3 = a2 + kstep; const char* b3 = b2 + kstep;
            PG8_LDB(B0, 0, 0); PG8_SCHED; PG8_LDA(At, 0, 0); PG8_STAGE(PG8_SA(1, 1), a1 + hstep);
            PG8_WAIT_L(8); PG8_BAR; PG8_WAIT_L(0); PG8_MMA(0, 0, At, B0); PG8_BAR; PG8_SCHED;
            PG8_LDB(B1, 0, 1); PG8_STAGE(PG8_SB(0, 0), b2);
            PG8_BAR; PG8_WAIT_L(0); PG8_MMA(0, 1, At, B1); PG8_BAR;
            PG8_LDA(At, 0, 1); PG8_STAGE(PG8_SA(0, 0), a2);
            PG8_BAR; PG8_WAIT_L(0); PG8_MMA(1, 0, At, B0); PG8_BAR; PG8_SCHED;
            PG8_STAGE(PG8_SB(0, 1), b2 + hstep);
            PG8_WAIT_V(6); PG8_BAR; PG8_MMA(1, 1, At, B1); PG8_BAR;
            PG8_LDB(B0, 1, 0); PG8_SCHED; PG8_LDA(At, 1, 0); PG8_STAGE(PG8_SA(0, 1), a2 + hstep);
            PG8_WAIT_L(8); PG8_BAR; PG8_WAIT_L(0); PG8_MMA(0, 0, At, B0); PG8_BAR; PG8_SCHED;
            PG8_LDB(B1, 1, 1); PG8_STAGE(PG8_SB(1, 0), b3);
            PG8_BAR; PG8_WAIT_L(0); PG8_MMA(0, 1, At, B1); PG8_BAR;
            PG8_LDA(At, 1, 1); PG8_STAGE(PG8_SA(1, 0), a3);
            PG8_BAR; PG8_WAIT_L(0); PG8_MMA(1, 0, At, B0); PG8_BAR; PG8_SCHED;
            PG8_STAGE(PG8_SB(1, 1), b3 + hstep);
            PG8_WAIT_V(6); PG8_BAR; PG8_MMA(1, 1, At, B1); PG8_BAR;
        }
        { int fr2 = lane, fq2; asm volatile("" : "+v"(fr2)); fq2 = fr2 >> 4; fr2 &= 15; epi_big(E, acc, cur, wr, wc, fr2, fq2); }
        if (!has_next) break;
#pragma unroll
        for (int a = 0; a < 2; ++a)
#pragma unroll
            for (int b = 0; b < 2; ++b)
#pragma unroll
                for (int m = 0; m < 4; ++m)
#pragma unroll
                    for (int n = 0; n < 2; ++n) acc[a][b][m][n] = (f32x4){0.f, 0.f, 0.f, 0.f};
        cur = nxt; cA = nA; cB = nB; ++ui;
    }
    PG8_WAIT_V(0);
    if (wr == 0) PG8_BAR;
    PG8_BAR;
}

template <class Epi>
DI void gemm_small(const u16* __restrict__ A, const u16* __restrict__ Bt, int K, int row0, int nrt, int nct, const Epi& E) {
    int tid = threadIdx.x; asm volatile("" : "+v"(tid));
    const int wid = tid >> 6, lane = tid & 63, fr = lane & 15, fq = lane >> 4;
    const int nun = nrt * nct;
    for (int t = (int)gridDim.x - 1 - (int)blockIdx.x; t < nun; t += gridDim.x) {
        const int rt = t % nrt, ct = t / nrt;
        const int c0 = Epi::DUAL ? ((ct * 32) >> 7) * 256 + ((ct * 32) & 127) : ct * 32;
        const int rbase = row0 + rt * 256 + wid * 32;
        f32x4 acc[2][2], acc2[2][2];
#pragma unroll
        for (int m = 0; m < 2; ++m)
#pragma unroll
            for (int n = 0; n < 2; ++n) { acc[m][n] = (f32x4){0.f, 0.f, 0.f, 0.f}; acc2[m][n] = (f32x4){0.f, 0.f, 0.f, 0.f}; }
        const u16* a0 = A + (size_t)(rbase + fr) * K + fq * 8;
        const u16* b0 = Bt + (size_t)(c0 + fr) * K + fq * 8;
#pragma unroll 2
        for (int k = 0; k < K; k += 32) {
            bf16x8 av[2], bv[2], bw[2];
            av[0] = *(const bf16x8*)(a0 + k); av[1] = *(const bf16x8*)(a0 + (size_t)16 * K + k);
            bv[0] = *(const bf16x8*)(b0 + k); bv[1] = *(const bf16x8*)(b0 + (size_t)16 * K + k);
            if (Epi::DUAL) { bw[0] = *(const bf16x8*)(b0 + (size_t)128 * K + k); bw[1] = *(const bf16x8*)(b0 + (size_t)144 * K + k); }
#pragma unroll
            for (int m = 0; m < 2; ++m)
#pragma unroll
                for (int n = 0; n < 2; ++n) {
                    acc[m][n] = __builtin_amdgcn_mfma_f32_16x16x32_bf16(bv[n], av[m], acc[m][n], 0, 0, 0);
                    if (Epi::DUAL) acc2[m][n] = __builtin_amdgcn_mfma_f32_16x16x32_bf16(bw[n], av[m], acc2[m][n], 0, 0, 0);
                }
        }
#pragma unroll
        for (int m = 0; m < 2; ++m) {
            const int row = rbase + m * 16 + fr;
            const float rs = E.rowscale(row);
            float s = 0.f;
#pragma unroll
            for (int n = 0; n < 2; ++n) s += E.quad(row, ct * 32 + n * 16 + fq * 4, acc[m][n], Epi::DUAL ? acc2[m][n] : acc[m][n], rs);
            if (Epi::SS) { s += __shfl_xor(s, 16); s += __shfl_xor(s, 32); if (fq == 0) E.addss(row, s); }
        }
    }
}

DI u32x2 pack4(f32x4 v) { u32x2 o; o.x = pack2(v[0], v[1]); o.y = pack2(v[2], v[3]); return o; }

struct EpiFfnUp {
    static constexpr bool DUAL = true, SS = false, CUSTOM = false;
    const float* ss; u16* act;
    DI float rowscale(int row) const { return rsqrtf(ss[row] * (1.f / DM) + EPS); }
    DI void addss(int, float) const {}
    DI float quad(int row, int col, f32x4 a, f32x4 b, float rs) const {
        f32x4 o;
#pragma unroll
        for (int e = 0; e < 4; ++e) o[e] = siluf(a[e] * rs) * (b[e] * rs);
        *(u32x2*)(act + (size_t)row * DFF + col) = pack4(o);
        return 0.f;
    }
};

template <int MODE, bool WHB>
struct EpiRes {
    static constexpr bool DUAL = false, SS = WHB, CUSTOM = false;
    float* h; u16* hb; const float* ss; float* ssn; const u16* pin; float alpha, invd;
    DI float rowscale(int row) const { return ss ? rsqrtf(ss[row] * invd + EPS) : 1.f; }
    DI void addss(int row, float s) const { atomicAdd(ssn + row, s); }
    DI float quad(int row, int col, f32x4 a, f32x4, float rs) const {
        const size_t o = (size_t)row * DM + col;
        f32x4 hv = *(const f32x4*)(h + o);
        if (MODE == 0) { hv += a * (alpha * rs); }
        else { u32x2 pv = *(const u32x2*)(pin + o);
            hv[0] += bf2f((u16)(pv.x & 0xffff)) * sigmf(rs * a[0]); hv[1] += bf2f((u16)(pv.x >> 16)) * sigmf(rs * a[1]);
            hv[2] += bf2f((u16)(pv.y & 0xffff)) * sigmf(rs * a[2]); hv[3] += bf2f((u16)(pv.y >> 16)) * sigmf(rs * a[3]); }
        *(f32x4*)(h + o) = hv;
        if (WHB) *(u32x2*)(hb + o) = pack4(hv);
        return hv[0] * hv[0] + hv[1] * hv[1] + hv[2] * hv[2] + hv[3] * hv[3];
    }
};

struct EpiInProj {
    static constexpr bool DUAL = false, SS = false, CUSTOM = false;
    const float* ss; u16* z; u16* xbc; float* dtraw; float* out;
    DI float rowscale(int row) const { return rsqrtf(ss[row] * (1.f / DM) + EPS); }
    DI void addss(int, float) const {}
    DI float quad(int row, int col, f32x4 a, f32x4, float rs) const {
        a *= rs;
        if (col < DIN) *(u32x2*)(z + (size_t)row * DIN + col) = pack4(a);
        else if (col < DIN + CONVD) {
            const int cc = col - DIN;
            *(u32x2*)(xbc + (size_t)row * CONVD + cc) = pack4(a);
            if (row < MP) { const int t = row & (SEQ - 1); if (t >= SEQ - 3) *(f32x4*)(out + O_CONVP + ((size_t)(row >> 11) * 3 + (t - (SEQ - 3))) * CONVD + cc) = a; }
            else { const int r = row - MP, t = r & 15; if (t >= DSEQ - 3) *(f32x4*)(out + O_CONVS + ((size_t)(r >> 4) * 3 + (t - (DSEQ - 3))) * CONVD + cc) = a; }
        } else if (col < NINA) *(f32x4*)(dtraw + (size_t)row * 32 + (col - DIN - CONVD)) = a;
        return 0.f;
    }
};

template <bool SSQ>
struct EpiPlain {
    static constexpr bool DUAL = false, SS = SSQ, CUSTOM = false;
    const float* ss; float invd; u16* out; int ldc; float* ssn;
    DI float rowscale(int row) const { return ss ? rsqrtf(ss[row] * invd + EPS) : 1.f; }
    DI void addss(int row, float s) const { atomicAdd(ssn + row, s); }
    DI float quad(int row, int col, f32x4 a, f32x4, float rs) const {
        a *= rs;
        *(u32x2*)(out + (size_t)row * ldc + col) = pack4(a);
        return a[0] * a[0] + a[1] * a[1] + a[2] * a[2] + a[3] * a[3];
    }
};
struct EpiKva {
    static constexpr bool DUAL = false, SS = true, CUSTOM = false;
    const float* ss; float* kvraw; float* ssn; int coloff;
    DI float rowscale(int row) const { return rsqrtf(ss[row] * (1.f / DM) + EPS); }
    DI void addss(int row, float s) const { atomicAdd(ssn + row, s); }
    DI float quad(int row, int col, f32x4 a, f32x4, float rs) const {
        a *= rs;
        *(f32x4*)(kvraw + (size_t)row * 288 + coloff + col) = a;
        return a[0] * a[0] + a[1] * a[1] + a[2] * a[2] + a[3] * a[3];
    }
};
struct EpiKvb {
    static constexpr bool DUAL = false, SS = false, CUSTOM = true;
    const float* knorm; u16* Kn; u16* Vt;
    DI float rowscale(int) const { return 1.f; }
    DI void addss(int, float) const {}
    DI float quad(int, int, f32x4, f32x4, float) const { return 0.f; }
    DI void custom(f32x4 (&acc)[2][2][4][2], const Unit& u, int wr, int wc, int fr, int fq) const {
        const int head = 2 * u.pn + (wc >> 1), part = wc & 1;
#pragma unroll
        for (int ai = 0; ai < 2; ++ai)
#pragma unroll
            for (int m = 0; m < 4; ++m) {
                const int row = u.pm * BM + ai * HALF + wr * 64 + m * 16 + fr;
                if (part == 0) {
                    float s = 0.f;
#pragma unroll
                    for (int bj = 0; bj < 2; ++bj)
#pragma unroll
                        for (int n = 0; n < 2; ++n) { const f32x4 a = acc[ai][bj][m][n]; s += a[0] * a[0] + a[1] * a[1] + a[2] * a[2] + a[3] * a[3]; }
                    s += __shfl_xor(s, 16); s += __shfl_xor(s, 32);
                    const float r = rsqrtf(s * (1.f / 64.f) + EPS);
#pragma unroll
                    for (int bj = 0; bj < 2; ++bj)
#pragma unroll
                        for (int n = 0; n < 2; ++n) {
                            const int idx0 = 32 * bj + 16 * n + 4 * fq;
                            const f32x4 g = *(const f32x4*)(knorm + idx0);
                            f32x4 a = acc[ai][bj][m][n] * r; a *= g;
                            *(u32x2*)(Kn + (size_t)row * 1024 + head * 64 + idx0) = pack4(a);
                        }
                } else {
                    const int b = row >> 11, sp = row & (SEQ - 1);
                    u16* vb = Vt + ((size_t)(b * 16 + head) * 64) * SEQ + sp;
#pragma unroll
                    for (int bj = 0; bj < 2; ++bj)
#pragma unroll
                        for (int n = 0; n < 2; ++n)
#pragma unroll
                            for (int e = 0; e < 4; ++e) vb[(size_t)(32 * bj + 16 * n + 4 * fq + e) * SEQ] = f2bf(acc[ai][bj][m][n][e]);
                }
                asm volatile("" ::: "memory");
            }
    }
};

DI void sincos_rev(float ang, float& sn, float& cs) { float rev = ang * 0.15915494309189535f; rev -= floorf(rev); sn = __builtin_amdgcn_sinf(rev); cs = __builtin_amdgcn_cosf(rev); }
DI void kvn_phase(const Params& P) {
    unsigned char* ws = P.ws;
    const float* kvraw = (const float*)(ws + E_KVRAW);
    const float* ss6 = (const float*)(ws + WS_SS) + 6 * MT; const float* ss7 = (const float*)(ws + WS_SS) + 7 * MT;
    u16* ckvp = (u16*)(ws + E_CKVP); u16* ckvs = (u16*)(ws + E_CKVS); u16* krp = (u16*)(ws + E_KRP); u16* krs = (u16*)(ws + E_KRS);
    int tid = threadIdx.x; asm volatile("" : "+v"(tid));
    const int wave = tid >> 6, lane = tid & 63;
    const f32x4 gk = *(const f32x4*)(P.in[30] + lane * 4);
    const float gr = P.in[31][lane & 31];
    const float inv = __expf(-(float)(lane & 15) * (9.210340371976184f / 16.f));
    for (int row = blockIdx.x * 8 + wave; row < MT; row += gridDim.x * 8) {
        const bool pr = row < MP;
        const int r = pr ? row : row - MP;
        const int bb = pr ? (r >> 11) : (r >> 4), t = pr ? (r & (SEQ - 1)) : (r & 15);
        const int pos = pr ? t : PAST + t;
        const float r6 = rsqrtf(ss6[row] * (1.f / 256.f) + EPS), r7 = rsqrtf(ss7[row] * (1.f / 32.f) + EPS);
        f32x4 v = *(const f32x4*)(kvraw + (size_t)row * 288 + lane * 4);
        v *= r6; v *= gk;
        *(f32x4*)(P.out + (pr ? O_KVP : O_KVS) + (size_t)r * 256 + lane * 4) = v;
        u16* cdst = pr ? ckvp + (size_t)r * 256 : ckvs + ((size_t)bb * SKV + PAST + t) * 256;
        *(u32x2*)(cdst + lane * 4) = pack4(v);
        float x = kvraw[(size_t)row * 288 + 256 + (lane & 31)] * r7 * gr;
        const float xp = __shfl_xor(x, 16);
        const float ang = (float)pos * inv;
        float sn, cs; sincos_rev(ang, sn, cs);
        const float o = (lane & 16) ? (xp * sn + x * cs) : (x * cs - xp * sn);
        if (lane < 32) {
            P.out[(pr ? O_KRP : O_KRS) + (size_t)r * 32 + lane] = o;
            u16* kdst = pr ? krp + (size_t)r * 32 : krs + ((size_t)bb * SKV + PAST + t) * 32;
            kdst[lane] = f2bf(o);
        }
    }
    const size_t gt = (size_t)blockIdx.x * NTHR + tid, gs = (size_t)gridDim.x * NTHR;
    for (size_t i = gt; i < (size_t)16 * PAST * 64; i += gs) {
        const size_t rr = i >> 6; const int c = (int)(i & 63) * 4;
        const size_t bb = rr >> 12, sidx = rr & (PAST - 1);
        const f32x4 v = *(const f32x4*)(P.in[6] + rr * 256 + c);
        *(u32x2*)(ckvs + (bb * SKV + sidx) * 256 + c) = pack4(v);
    }
    for (size_t i = gt; i < (size_t)16 * PAST * 8; i += gs) {
        const size_t rr = i >> 3; const int c = (int)(i & 7) * 4;
        const size_t bb = rr >> 12, sidx = rr & (PAST - 1);
        const f32x4 v = *(const f32x4*)(P.in[7] + rr * 32 + c);
        *(u32x2*)(krs + (bb * SKV + sidx) * 32 + c) = pack4(v);
    }
}

constexpr int LDK = 104, LDV = 72, LDC = 264;
constexpr int AT_KS = 0, AT_VT = 13312, AT_KS2 = 22528, AT_VT2 = 35840, AT_CKV = 45056, AT_KNSQ = 78848;
constexpr float QSCALE = 0.10206207261596575f * 1.4426950408889634f;

DI void load_q(const u16* qraw, int row, int h, int pos, bool valid, const float* gn, const float* gr, int hf, bf16x8 (&qf)[6]) {
    float v[6][8];
#pragma unroll
    for (int ks = 0; ks < 6; ++ks) {
        u32x4 w = mk4(0, 0, 0, 0);
        if (valid) w = *(const u32x4*)(qraw + (size_t)row * 1536 + h * 96 + 16 * ks + 8 * hf);
        const unsigned wv[4] = {w.x, w.y, w.z, w.w};
#pragma unroll
        for (int j = 0; j < 8; ++j) v[ks][j] = bf2f((u16)((j & 1) ? (wv[j >> 1] >> 16) : (wv[j >> 1] & 0xffff)));
    }
    float sn = 0.f, sr = 0.f;
#pragma unroll
    for (int ks = 0; ks < 4; ++ks)
#pragma unroll
        for (int j = 0; j < 8; ++j) sn += v[ks][j] * v[ks][j];
#pragma unroll
    for (int ks = 4; ks < 6; ++ks)
#pragma unroll
        for (int j = 0; j < 8; ++j) sr += v[ks][j] * v[ks][j];
    sn += __shfl_xor(sn, 32); sr += __shfl_xor(sr, 32);
    const float rn = rsqrtf(sn * (1.f / 64.f) + EPS) * QSCALE, rr = rsqrtf(sr * (1.f / 32.f) + EPS) * QSCALE;
#pragma unroll
    for (int ks = 0; ks < 4; ++ks) {
        unsigned pk[4];
#pragma unroll
        for (int j = 0; j < 8; j += 2) pk[j >> 1] = pack2(v[ks][j] * rn * gn[16 * ks + 8 * hf + j], v[ks][j + 1] * rn * gn[16 * ks + 8 * hf + j + 1]);
        u32x4 u = mk4(pk[0], pk[1], pk[2], pk[3]); qf[ks] = __builtin_bit_cast(bf16x8, u);
    }
    float o1[8], o2[8];
#pragma unroll
    for (int j = 0; j < 8; ++j) {
        const int ri = 8 * hf + j;
        const float x1 = v[4][j] * rr * gr[ri], x2 = v[5][j] * rr * gr[ri + 16];
        const float ang = (float)pos * __expf(-(float)ri * (9.210340371976184f / 16.f));
        float sn_, cs_; sincos_rev(ang, sn_, cs_);
        o1[j] = x1 * cs_ - x2 * sn_; o2[j] = x1 * sn_ + x2 * cs_;
    }
    { unsigned pk[4], pk2[4];
#pragma unroll
      for (int j = 0; j < 8; j += 2) { pk[j >> 1] = pack2(o1[j], o1[j + 1]); pk2[j >> 1] = pack2(o2[j], o2[j + 1]); }
      u32x4 u = mk4(pk[0], pk[1], pk[2], pk[3]); qf[4] = __builtin_bit_cast(bf16x8, u);
      u32x4 u2 = mk4(pk2[0], pk2[1], pk2[2], pk2[3]); qf[5] = __builtin_bit_cast(bf16x8, u2); }
}

DI void attn_step(const LAS u16* Ks, const LAS u16* Vt, const bf16x8 (&qf)[6], f32x16 (&oacc)[2], float& mrun, float& lrun, int nvalid, int l31, int hf) {
    f32x16 sacc[2];
#pragma unroll
    for (int kb = 0; kb < 2; ++kb) {
#pragma unroll
        for (int i = 0; i < 16; ++i) sacc[kb][i] = 0.f;
#pragma unroll
        for (int ks = 0; ks < 6; ++ks) {
            const bf16x8 a = *(const LAS bf16x8*)(Ks + (32 * kb + l31) * LDK + 16 * ks + 8 * hf);
            sacc[kb] = MFMA32(a, qf[ks], sacc[kb]);
        }
        asm volatile("" ::: "memory");
    }
    float mx = -1e30f;
#pragma unroll
    for (int kb = 0; kb < 2; ++kb)
#pragma unroll
        for (int i = 0; i < 16; ++i) {
            const int key = 32 * kb + (i & 3) + 8 * (i >> 2) + 4 * hf;
            if (key >= nvalid) sacc[kb][i] = -1e30f;
            mx = fmaxf(mx, sacc[kb][i]);
        }
    mx = fmaxf(mx, __shfl_xor(mx, 32));
    const float mnew = fmaxf(mrun, mx);
    const float alpha = __builtin_amdgcn_exp2f(mrun - mnew);
    mrun = mnew;
    float ls = 0.f;
#pragma unroll
    for (int kb = 0; kb < 2; ++kb)
#pragma unroll
        for (int i = 0; i < 16; ++i) { const float p = __builtin_amdgcn_exp2f(sacc[kb][i] - mnew); sacc[kb][i] = p; ls += p; }
    lrun = lrun * alpha + ls;
#pragma unroll
    for (int db = 0; db < 2; ++db)
#pragma unroll
        for (int i = 0; i < 16; ++i) oacc[db][i] *= alpha;
#pragma unroll
    for (int kb = 0; kb < 2; ++kb)
#pragma unroll
        for (int s2 = 0; s2 < 2; ++s2) {
            unsigned pk[4];
#pragma unroll
            for (int j = 0; j < 8; j += 2) pk[j >> 1] = pack2(sacc[kb][8 * s2 + j], sacc[kb][8 * s2 + j + 1]);
            const u32x4 pu = mk4(pk[0], pk[1], pk[2], pk[3]);
            const bf16x8 pf = __builtin_bit_cast(bf16x8, pu);
#pragma unroll
            for (int db = 0; db < 2; ++db) {
                const LAS u16* vp = Vt + (32 * db + l31) * LDV + 32 * kb + 16 * s2 + 4 * hf;
                const u32x2 lo = *(const LAS u32x2*)vp, hi = *(const LAS u32x2*)(vp + 8);
                const u32x4 vu = mk4(lo.x, lo.y, hi.x, hi.y);
                oacc[db] = MFMA32(__builtin_bit_cast(bf16x8, vu), pf, oacc[db]);
            }
            asm volatile("" ::: "memory");
        }
}

DI void attn_store(u16* o, int row, int h, const f32x16 (&oacc)[2], float lrun, int hf, bool valid) {
    const float lt = lrun + __shfl_xor(lrun, 32);
    const float il = 1.f / lt;
    if (valid) {
#pragma unroll
        for (int db = 0; db < 2; ++db)
#pragma unroll
            for (int q = 0; q < 4; ++q) {
                f32x4 v = {oacc[db][4 * q] * il, oacc[db][4 * q + 1] * il, oacc[db][4 * q + 2] * il, oacc[db][4 * q + 3] * il};
                *(u32x2*)(o + (size_t)row * 1024 + h * 64 + 32 * db + 8 * q + 4 * hf) = pack4(v);
            }
    }
}

DI void attn_phase(const Params& P) {
    unsigned char* ws = P.ws;
    LAS unsigned char* lds = (LAS unsigned char*)smem;
    int tid = threadIdx.x; asm volatile("" : "+v"(tid));
    const int wid = __builtin_amdgcn_readfirstlane(tid >> 6), lane = tid & 63, l31 = lane & 31, hf = lane >> 5;
    const u16* qraw = (const u16*)(ws + E_QRAW);
    u16* obuf = (u16*)(ws + E_O);
    const float* gn = P.in[37]; const float* gr = P.in[38];
    {
        const u16* ckvs = (const u16*)(ws + E_CKVS); const u16* krs = (const u16*)(ws + E_KRS);
        const u16* wkvb = (const u16*)(ws + W_KVBS);
        LAS u16* Ks = (LAS u16*)(lds + AT_KS); LAS u16* Vt = (LAS u16*)(lds + AT_VT); LAS u16* Ct = (LAS u16*)(lds + AT_CKV);
        LAS float* knsq = (LAS float*)(lds + AT_KNSQ);
        for (int item = blockIdx.x; item < 256; item += gridDim.x) {
            const int b = item >> 4, h = item & 15;
            const int kb = wid & 1, part = wid >> 2, half = (wid >> 1) & 1;
            bf16x8 qf[6]; f32x16 oacc[2]; float mrun = -1e30f, lrun = 0.f;
#pragma unroll
            for (int db = 0; db < 2; ++db)
#pragma unroll
                for (int i = 0; i < 16; ++i) oacc[db][i] = 0.f;
            const bool qvalid = l31 < 16;
            if (wid == 0) load_q(qraw, MP + b * 16 + l31, h, PAST + l31, qvalid, gn, gr, hf, qf);
            asm volatile("" ::: "memory");
            bf16x8 wf[16];
            { const u16* wrow = wkvb + (size_t)(h * 128 + part * 64 + half * 32 + l31) * 256 + 8 * hf;
#pragma unroll
              for (int ks = 0; ks < 16; ++ks) wf[ks] = *(const bf16x8*)(wrow + 16 * ks); }
            for (int tile = 0; tile < 65; ++tile) {
                const int k0 = tile * 64, nv = (SKV - k0) < 64 ? (SKV - k0) : 64;
                __syncthreads();
#pragma unroll
                for (int c = 0; c < 4; ++c) {
                    const int ci = tid + c * NTHR, key = ci >> 5, cc = (ci & 31) * 8;
                    u32x4 v = mk4(0, 0, 0, 0);
                    if (key < nv) v = *(const u32x4*)(ckvs + ((size_t)b * SKV + k0 + key) * 256 + cc);
                    *(LAS u32x4*)(Ct + key * LDC + cc) = v;
                }
                if (tid < 256) {
                    const int key = tid >> 2, cc = (tid & 3) * 8;
                    u32x4 v = mk4(0, 0, 0, 0);
                    if (key < nv) v = *(const u32x4*)(krs + ((size_t)b * SKV + k0 + key) * 32 + cc);
                    *(LAS u32x4*)(Ks + key * LDK + 64 + cc) = v;
                }
                __syncthreads();
                f32x16 e;
#pragma unroll
                for (int i = 0; i < 16; ++i) e[i] = 0.f;
#pragma unroll
                for (int ks = 0; ks < 16; ++ks) {
                    const bf16x8 bfr = *(const LAS bf16x8*)(Ct + (32 * kb + l31) * LDC + 16 * ks + 8 * hf);
                    e = MFMA32(wf[ks], bfr, e);
                }
                const int key = 32 * kb + l31;
                if (part == 0) {
                    float sq = 0.f;
#pragma unroll
                    for (int i = 0; i < 16; ++i) sq += e[i] * e[i];
                    sq += __shfl_xor(sq, 32);
                    if (hf == 0) knsq[half * 64 + key] = sq;
                } else {
#pragma unroll
                    for (int i = 0; i < 16; ++i) Vt[(32 * half + (i & 3) + 8 * (i >> 2) + 4 * hf) * LDV + key] = f2bf(e[i]);
                }
                __syncthreads();
                if (part == 0) {
                    const float r = rsqrtf((knsq[key] + knsq[64 + key]) * (1.f / 64.f) + EPS);
#pragma unroll
                    for (int q = 0; q < 4; ++q) {
                        const f32x4 g = *(const f32x4*)(P.in[33] + 32 * half + 8 * q + 4 * hf);
                        f32x4 v = {e[4 * q] * r * g[0], e[4 * q + 1] * r * g[1], e[4 * q + 2] * r * g[2], e[4 * q + 3] * r * g[3]};
                        *(LAS u32x2*)(Ks + key * LDK + 32 * half + 8 * q + 4 * hf) = pack4(v);
                    }
                }
                __syncthreads();
                if (wid == 0) attn_step(Ks, Vt, qf, oacc, mrun, lrun, nv, l31, hf);
            }
            if (wid == 0) attn_store(obuf, MP + b * 16 + l31, h, oacc, lrun, hf, qvalid);
            __syncthreads();
        }
    }
    {
        const u16* Kn = (const u16*)(ws + E_KN); const u16* Vtg = (const u16*)(ws + E_VT); const u16* krp = (const u16*)(ws + E_KRP);
        for (int item = blockIdx.x; item < 2048; item += gridDim.x) {
            const int qb = 7 - (item >> 8), bh = item & 255, b = bh >> 4, h = bh & 15;
            const int q0 = qb * 256 + wid * 32;
            const int ntiles = 4 * qb + 4, mylast = 4 * qb + (wid >> 1);
            bf16x8 qf[6]; f32x16 oacc[2]; float mrun = -1e30f, lrun = 0.f;
#pragma unroll
            for (int db = 0; db < 2; ++db)
#pragma unroll
                for (int i = 0; i < 16; ++i) oacc[db][i] = 0.f;
            load_q(qraw, b * SEQ + q0 + l31, h, q0 + l31, true, gn, gr, hf, qf);
            const int lk = tid >> 3, lc = (tid & 7) * 8;
            const u16* kgp = Kn + ((size_t)(b * SEQ + lk)) * 1024 + h * 64 + lc;
            const u16* rgp = krp + ((size_t)(b * SEQ + (tid >> 2))) * 32 + (tid & 3) * 8;
            const u16* vgp = Vtg + ((size_t)((b * 16 + h) * 64 + lk)) * SEQ + lc;
            u32x4 kreg = *(const u32x4*)kgp, vreg = *(const u32x4*)vgp, rreg = mk4(0, 0, 0, 0);
            if (tid < 256) rreg = *(const u32x4*)rgp;
            for (int kt = 0; kt < ntiles; ++kt) {
                LAS u16* Ks = (LAS u16*)(lds + ((kt & 1) ? AT_KS2 : AT_KS)); LAS u16* Vt = (LAS u16*)(lds + ((kt & 1) ? AT_VT2 : AT_VT));
                *(LAS u32x4*)(Ks + lk * LDK + lc) = kreg;
                *(LAS u32x4*)(Vt + lk * LDV + lc) = vreg;
                if (tid < 256) *(LAS u32x4*)(Ks + (tid >> 2) * LDK + 64 + (tid & 3) * 8) = rreg;
                if (kt + 1 < ntiles) {
                    kreg = *(const u32x4*)(kgp + (size_t)(kt + 1) * 64 * 1024);
                    vreg = *(const u32x4*)(vgp + (kt + 1) * 64);
                    if (tid < 256) rreg = *(const u32x4*)(rgp + (size_t)(kt + 1) * 64 * 32);
                }
                __syncthreads();
                if (kt <= mylast) attn_step(Ks, Vt, qf, oacc, mrun, lrun, 64, l31, hf);
            }
            attn_store(obuf, b * SEQ + q0 + l31, h, oacc, lrun, hf, true);
            __syncthreads();
        }
    }
}

constexpr int SC_DT = 0, SC_ACS = 256, SC_XN = 512, SC_XT = 9728, SC_BN = 18944, SC_CN = 36352, SC_BWT = 53760, SC_GM = 72192, SC_SB = 81408;
constexpr int LDX = 72, LDN = 136;

DI void scan_phase(const Params& P) {
    unsigned char* ws = P.ws;
    LAS unsigned char* lds = (LAS unsigned char*)smem;
    LAS float* s_dt = (LAS float*)(lds + SC_DT);
    LAS float* s_acs = (LAS float*)(lds + SC_ACS);
    LAS u16* xs_nat = (LAS u16*)(lds + SC_XN);
    LAS u16* xT = (LAS u16*)(lds + SC_XT);
    LAS u16* Bnat = (LAS u16*)(lds + SC_BN);
    LAS u16* Cnat = (LAS u16*)(lds + SC_CN);
    LAS u16* BwT = (LAS u16*)(lds + SC_BWT);
    LAS u16* Gm = (LAS u16*)(lds + SC_GM);
    LAS u16* Sb = (LAS u16*)(lds + SC_SB);
    int tid = threadIdx.x; asm volatile("" : "+v"(tid));
    const int wid = __builtin_amdgcn_readfirstlane(tid >> 6), lane = tid & 63, l31 = lane & 31, hf = lane >> 5;
    u16* zb = (u16*)(ws + R_Z);
    const u16* xbc = (const u16*)(ws + R_XBC);
    const float* dtraw = (const float*)(ws + R_DT);
    float* ssa = (float*)(ws + WS_SS) + 2 * MT;
    const float* convw = P.in[21]; const float* convb = P.in[22];

    for (int item = blockIdx.x; item < 1024; item += gridDim.x) {
        const bool samp = item >= 512;
        const int bi = (item & 511) >> 5, h = item & 31, g = h >> 3;
        const int nchunks = samp ? 1 : 32, nvalid = samp ? 16 : 64;
        const int rowbase = samp ? MP + bi * 16 : bi * SEQ;
        const float A_h = -__expf(P.in[24][h]), dtb = P.in[23][h], Dh = P.in[25][h];
        f32x16 st;
        const int sp = 32 * (wid & 1) + l31, sn0 = 32 * (wid >> 1) + 4 * hf;
        if (samp) {
            const float* src = P.in[5] + ((size_t)(bi * 32 + h) * 64 + sp) * 128 + sn0;
#pragma unroll
            for (int q = 0; q < 4; ++q) { f32x4 v = *(const f32x4*)(src + 8 * q); st[4 * q] = v[0]; st[4 * q + 1] = v[1]; st[4 * q + 2] = v[2]; st[4 * q + 3] = v[3]; }
        } else {
#pragma unroll
            for (int i = 0; i < 16; ++i) st[i] = 0.f;
        }
        __syncthreads();
#pragma unroll
        for (int q = 0; q < 4; ++q) { f32x4 v = {st[4 * q], st[4 * q + 1], st[4 * q + 2], st[4 * q + 3]}; *(LAS u32x2*)(Sb + sp * LDN + sn0 + 8 * q) = pack4(v); }
        const int cgi = tid % 40, tseg = tid / 40, vc = cgi * 8;
        const bool cthr = tid < 320;
        int gcol = 0;
        if (vc < 64) gcol = h * 64 + vc; else if (vc < 192) gcol = 2048 + g * 128 + (vc - 64); else gcol = 2560 + g * 128 + (vc - 192);
        for (int ch = 0; ch < nchunks; ++ch) {
            const int t0 = ch * 64, r0 = rowbase + t0;
            if (wid == 0) {
                float dtv = 0.f;
                if (lane < nvalid) { float x = dtraw[(size_t)(r0 + lane) * 32 + h] + dtb; dtv = x > 20.f ? x : log1pf(__expf(x)); }
                float a = dtv * A_h;
#pragma unroll
                for (int o = 1; o < 64; o <<= 1) { float t = __shfl_up(a, o); if (lane >= o) a += t; }
                s_dt[lane] = dtv; s_acs[lane] = a;
            }
            u32x4 raw[11];
            if (cthr) {
#pragma unroll
                for (int j = 0; j < 11; ++j) {
                    const int tt = 8 * tseg - 3 + j;
                    const int tabs = t0 + tt;
                    u32x4 v = mk4(0, 0, 0, 0);
                    if (tabs >= 0) { if (tabs < (samp ? 16 : SEQ)) v = *(const u32x4*)(xbc + (size_t)(rowbase + tabs) * CONVD + gcol); }
                    else if (samp) { const float* sc = P.in[4] + ((size_t)bi * 3 + (tabs + 3)) * CONVD + gcol;
                        f32x4 a = *(const f32x4*)sc, b = *(const f32x4*)(sc + 4);
                        v.x = pack2(a[0], a[1]); v.y = pack2(a[2], a[3]); v.z = pack2(b[0], b[1]); v.w = pack2(b[2], b[3]); }
                    raw[j] = v;
                }
            }
            __syncthreads();
            const float acs_end = s_acs[63];
            if (cthr) {
#pragma unroll
                for (int eh = 0; eh < 2; ++eh) {
                    float wk[4][4], bs[4];
#pragma unroll
                    for (int k = 0; k < 4; ++k) { const f32x4 a = *(const f32x4*)(convw + k * CONVD + gcol + 4 * eh); wk[k][0] = a[0]; wk[k][1] = a[1]; wk[k][2] = a[2]; wk[k][3] = a[3]; }
                    { const f32x4 a = *(const f32x4*)(convb + gcol + 4 * eh); bs[0] = a[0]; bs[1] = a[1]; bs[2] = a[2]; bs[3] = a[3]; }
                    unsigned colpk[4][4];
#pragma unroll
                    for (int j = 0; j < 8; ++j) {
                        const int tl = 8 * tseg + j;
                        float o[4];
#pragma unroll
                        for (int e = 0; e < 4; ++e) o[e] = bs[e];
#pragma unroll
                        for (int k = 0; k < 4; ++k) {
                            const u32x4 v = raw[j + k];
                            const unsigned w0 = eh ? v.z : v.x, w1 = eh ? v.w : v.y;
                            o[0] += wk[k][0] * bf2f((u16)(w0 & 0xffff)); o[1] += wk[k][1] * bf2f((u16)(w0 >> 16));
                            o[2] += wk[k][2] * bf2f((u16)(w1 & 0xffff)); o[3] += wk[k][3] * bf2f((u16)(w1 >> 16));
                        }
                        float wsc = 1.f;
                        if (vc >= 64 && vc < 192) wsc = s_dt[tl] * __expf(acs_end - s_acs[tl]);
#pragma unroll
                        for (int e = 0; e < 4; ++e) o[e] = siluf(o[e]);
                        u32x2 nat; nat.x = pack2(o[0], o[1]); nat.y = pack2(o[2], o[3]);
                        if (vc < 64) *(LAS u32x2*)(xs_nat + tl * LDX + vc + 4 * eh) = nat;
                        else if (vc < 192) *(LAS u32x2*)(Bnat + tl * LDN + (vc - 64) + 4 * eh) = nat;
                        else *(LAS u32x2*)(Cnat + tl * LDN + (vc - 192) + 4 * eh) = nat;
#pragma unroll
                        for (int e = 0; e < 4; ++e) {
                            const unsigned bits = (unsigned)f2bf(o[e] * wsc);
                            if (j & 1) colpk[e][j >> 1] |= bits << 16; else colpk[e][j >> 1] = bits;
                        }
                    }
                    if (vc < 192) {
#pragma unroll
                        for (int e = 0; e < 4; ++e) {
                            u32x4 tv; tv.x = colpk[e][0]; tv.y = colpk[e][1]; tv.z = colpk[e][2]; tv.w = colpk[e][3];
                            if (vc < 64) *(LAS u32x4*)(xT + (vc + 4 * eh + e) * LDX + 8 * tseg) = tv;
                            else *(LAS u32x4*)(BwT + (vc - 64 + 4 * eh + e) * LDX + 8 * tseg) = tv;
                        }
                    }
                    asm volatile("" ::: "memory");
                }
            }
            __syncthreads();
            f32x16 yacc;
#pragma unroll
            for (int i = 0; i < 16; ++i) yacc[i] = 0.f;
            const int w4 = wid & 3, blkA = w4 >> 1, blkB = w4 & 1;
            if (wid < 4) {
                f32x16 cb;
#pragma unroll
                for (int i = 0; i < 16; ++i) cb[i] = 0.f;
#pragma unroll
                for (int ks = 0; ks < 8; ++ks) {
                    const bf16x8 a = *(const LAS bf16x8*)(Bnat + (32 * blkA + l31) * LDN + 16 * ks + 8 * hf);
                    const bf16x8 b = *(const LAS bf16x8*)(Cnat + (32 * blkB + l31) * LDN + 16 * ks + 8 * hf);
                    cb = MFMA32(a, b, cb);
                }
                const int lidx = 32 * blkB + l31;
                const float acl = s_acs[lidx];
#pragma unroll
                for (int q = 0; q < 4; ++q) {
                    const int sb0 = 32 * blkA + 8 * q + 4 * hf;
                    const f32x4 as4 = *(const LAS f32x4*)(s_acs + sb0);
                    const f32x4 dt4 = *(const LAS f32x4*)(s_dt + sb0);
                    f32x4 gv;
#pragma unroll
                    for (int e = 0; e < 4; ++e) { const float d = acl - as4[e]; gv[e] = (lidx >= sb0 + e) ? cb[4 * q + e] * __expf(fminf(d, 0.f)) * dt4[e] : 0.f; }
                    *(LAS u32x2*)(Gm + lidx * LDX + sb0) = pack4(gv);
                }
            } else {
#pragma unroll
                for (int ks = 0; ks < 8; ++ks) {
                    const bf16x8 a = *(const LAS bf16x8*)(Sb + (32 * blkA + l31) * LDN + 16 * ks + 8 * hf);
                    const bf16x8 b = *(const LAS bf16x8*)(Cnat + (32 * blkB + l31) * LDN + 16 * ks + 8 * hf);
                    yacc = MFMA32(a, b, yacc);
                }
                const float el = __expf(s_acs[32 * blkB + l31]);
#pragma unroll
                for (int i = 0; i < 16; ++i) yacc[i] *= el;
            }
            __syncthreads();
            if (wid >= 4) {
#pragma unroll
                for (int ks = 0; ks < 4; ++ks) {
                    const bf16x8 a = *(const LAS bf16x8*)(xT + (32 * blkA + l31) * LDX + 16 * ks + 8 * hf);
                    const bf16x8 b = *(const LAS bf16x8*)(Gm + (32 * blkB + l31) * LDX + 16 * ks + 8 * hf);
                    yacc = MFMA32(a, b, yacc);
                }
                const int lidx = 32 * blkB + l31;
                float ssum = 0.f;
                if (lidx < nvalid) {
                    const size_t zoff = (size_t)(r0 + lidx) * DIN + h * 64;
#pragma unroll
                    for (int q = 0; q < 4; ++q) {
                        const int p0 = 32 * blkA + 8 * q + 4 * hf;
                        const u32x2 zv = *(const u32x2*)(zb + zoff + p0);
                        const u32x2 xv = *(const LAS u32x2*)(xs_nat + lidx * LDX + p0);
                        const float zf[4] = {bf2f((u16)(zv.x & 0xffff)), bf2f((u16)(zv.x >> 16)), bf2f((u16)(zv.y & 0xffff)), bf2f((u16)(zv.y >> 16))};
                        const float xf[4] = {bf2f((u16)(xv.x & 0xffff)), bf2f((u16)(xv.x >> 16)), bf2f((u16)(xv.y & 0xffff)), bf2f((u16)(xv.y >> 16))};
                        f32x4 gv;
#pragma unroll
                        for (int e = 0; e < 4; ++e) { const float yv = yacc[4 * q + e] + Dh * xf[e]; gv[e] = yv * siluf(zf[e]); ssum += gv[e] * gv[e]; }
                        *(u32x2*)(zb + zoff + p0) = pack4(gv);
                    }
                }
                ssum += __shfl_xor(ssum, 32);
                if (hf == 0 && lidx < nvalid) atomicAdd(ssa + r0 + lidx, ssum);
            }
            {
                const float dec = __expf(acs_end);
#pragma unroll
                for (int i = 0; i < 16; ++i) st[i] *= dec;
#pragma unroll
                for (int ks = 0; ks < 4; ++ks) {
                    const bf16x8 a = *(const LAS bf16x8*)(BwT + (32 * (wid >> 1) + l31) * LDX + 16 * ks + 8 * hf);
                    const bf16x8 b = *(const LAS bf16x8*)(xT + (32 * (wid & 1) + l31) * LDX + 16 * ks + 8 * hf);
                    st = MFMA32(a, b, st);
                }
#pragma unroll
                for (int q = 0; q < 4; ++q) { f32x4 v = {st[4 * q], st[4 * q + 1], st[4 * q + 2], st[4 * q + 3]}; *(LAS u32x2*)(Sb + sp * LDN + sn0 + 8 * q) = pack4(v); }
            }
            __syncthreads();
        }
        {
            float* dst = P.out + (samp ? O_SSMS : O_SSMP) + ((size_t)(bi * 32 + h) * 64 + sp) * 128 + sn0;
#pragma unroll
            for (int q = 0; q < 4; ++q) { f32x4 v = {st[4 * q], st[4 * q + 1], st[4 * q + 2], st[4 * q + 3]}; *(f32x4*)(dst + 8 * q) = v; }
        }
    }
}

template <int ph>
DI void run_phase(const Params& P) {
    unsigned char* ws = P.ws;
    float* ssb = (float*)(ws + WS_SS);
    u16* hb = (u16*)(ws + WS_HB);
    switch (ph) {

        case 0: prep_phase(P); break;
        case 1: case 6: case 10: case 16: {
            const size_t wo = ph == 1 ? W_GU1_0 : ph == 6 ? W_GU2_0 : ph == 10 ? W_GU1_1 : W_GU2_1;
            const int si = ph == 1 ? 0 : ph == 6 ? 3 : ph == 10 ? 5 : 10;
            EpiFfnUp e; e.ss = ssb + si * MT; e.act = (u16*)(ws + (ph < 10 ? R_ACT : E_ACT));
            gemm_big(hb, (const u16*)(ws + wo), DM, MP / 256, 22, e);
            gemm_small(hb, (const u16*)(ws + wo), DM, MP, 1, DFF / 32, e);
            if (ph == 10) {
                EpiKva k; k.ss = ssb + 5 * MT; k.kvraw = (float*)(ws + E_KVRAW); k.ssn = ssb + 6 * MT; k.coloff = 0;
                const u16* wk = (const u16*)(ws + W_GU1_1) + (size_t)5632 * DM;
                gemm_big(hb, wk, DM, MP / 256, 1, k);
                gemm_small(hb, wk, DM, MP, 1, 8, k);
                EpiKva k2 = k; k2.ssn = ssb + 7 * MT; k2.coloff = 256;
                gemm_small(hb, wk + (size_t)256 * DM, DM, 0, 129, 1, k2);
            }
            if (ph == 16) pconv(P, 1, (u16*)(ws + E_PB1));
        } break;
        case 2: case 7: case 11: case 17: {
            const size_t wo = ph == 2 ? W_D1_0 : ph == 7 ? W_D2_0 : ph == 11 ? W_D1_1 : W_D2_1;
            const int so = ph == 2 ? 1 : ph == 7 ? 4 : ph == 11 ? 8 : 11;
            const u16* act = (const u16*)(ws + (ph < 10 ? R_ACT : E_ACT));
            EpiRes<0, true> e; e.h = P.out; e.hb = hb; e.ss = nullptr; e.ssn = ssb + so * MT; e.pin = nullptr; e.alpha = 0.5f; e.invd = 0.f;
            gemm_big(act, (const u16*)(ws + wo), DFF, MP / 256, 4, e);
            gemm_small(act, (const u16*)(ws + wo), DFF, MP, 1, DM / 32, e);
            if (ph == 11) kvn_phase(P);
        } break;
        case 3: {
            EpiInProj e; e.ss = ssb + 1 * MT; e.z = (u16*)(ws + R_Z); e.xbc = (u16*)(ws + R_XBC); e.dtraw = (float*)(ws + R_DT); e.out = P.out;
            gemm_big(hb, (const u16*)(ws + W_IN), DM, MP / 256, NINP / 256, e);
            gemm_small(hb, (const u16*)(ws + W_IN), DM, MP, 1, NINA / 32, e);
        } break;
        case 4: scan_phase(P); break;
        case 5: {
            EpiRes<0, true> e; e.h = P.out; e.hb = hb; e.ss = ssb + 2 * MT; e.ssn = ssb + 3 * MT; e.pin = nullptr; e.alpha = 1.f; e.invd = 1.f / DIN;
            gemm_big((const u16*)(ws + R_Z), (const u16*)(ws + W_OUT), DIN, MP / 256, 4, e);
            gemm_small((const u16*)(ws + R_Z), (const u16*)(ws + W_OUT), DIN, MP, 1, DM / 32, e);
        } break;
        case 8: case 18: {
            EpiPlain<false> e; e.ss = nullptr; e.invd = 0.f; e.out = (u16*)(ws + (ph == 8 ? R_PIN : E_PIN)); e.ldc = DM; e.ssn = nullptr;
            const u16* pb = (const u16*)(ws + (ph == 8 ? WS_PB0 : E_PB1));
            const u16* w = (const u16*)(ws + (ph == 8 ? W_PI_0 : W_PI_1));
            gemm_big(pb, w, 256, MP / 256, 4, e);
            gemm_small(pb, w, 256, MP, 1, DM / 32, e);
        } break;
        case 9: {
            EpiRes<1, true> e; e.h = P.out; e.hb = hb; e.ss = ssb + 4 * MT; e.ssn = ssb + 5 * MT; e.pin = (const u16*)(ws + R_PIN); e.alpha = 1.f; e.invd = 1.f / DM;
            gemm_big(hb, (const u16*)(ws + W_PG_0), DM, MP / 256, 4, e);
            gemm_small(hb, (const u16*)(ws + W_PG_0), DM, MP, 1, DM / 32, e);
        } break;
        case 19: {
            EpiRes<1, false> e; e.h = P.out; e.hb = hb; e.ss = ssb + 11 * MT; e.ssn = nullptr; e.pin = (const u16*)(ws + E_PIN); e.alpha = 1.f; e.invd = 1.f / DM;
            gemm_big(hb, (const u16*)(ws + W_PG_1), DM, MP / 256, 4, e);
            gemm_small(hb, (const u16*)(ws + W_PG_1), DM, MP, 1, DM / 32, e);
        } break;
        case 12: {
            EpiPlain<true> e; e.ss = ssb + 8 * MT; e.invd = 1.f / DM; e.out = (u16*)(ws + E_CQ); e.ldc = 512; e.ssn = ssb + 9 * MT;
            gemm_big(hb, (const u16*)(ws + W_DQ), DM, MP / 256, 2, e);
            gemm_small(hb, (const u16*)(ws + W_DQ), DM, MP, 1, 16, e);
            EpiKvb k; k.knorm = P.in[33]; k.Kn = (u16*)(ws + E_KN); k.Vt = (u16*)(ws + E_VT);
            gemm_big((const u16*)(ws + E_CKVP), (const u16*)(ws + W_KVB), 256, MP / 256, 8, k);
        } break;
        case 13: {
            EpiPlain<false> e; e.ss = ssb + 9 * MT; e.invd = 1.f / 512.f; e.out = (u16*)(ws + E_QRAW); e.ldc = 1536; e.ssn = nullptr;
            gemm_big((const u16*)(ws + E_CQ), (const u16*)(ws + W_QB), 512, MP / 256, 6, e);
            gemm_small((const u16*)(ws + E_CQ), (const u16*)(ws + W_QB), 512, MP, 1, 48, e);
        } break;
        case 14: attn_phase(P); break;
        case 15: {
            EpiRes<0, true> e; e.h = P.out; e.hb = hb; e.ss = nullptr; e.ssn = ssb + 10 * MT; e.pin = nullptr; e.alpha = 1.f; e.invd = 0.f;
            gemm_big((const u16*)(ws + E_O), (const u16*)(ws + W_O), DM, MP / 256, 4, e);
            gemm_small((const u16*)(ws + E_O), (const u16*)(ws + W_O), DM, MP, 1, DM / 32, e);
        } break;
        default: break;
    }
}

__global__ void __launch_bounds__(NTHR) yoco_fwd(Params P) {
    cg::grid_group grid = cg::this_grid();
#define PH(k) if (P.ph_lo <= k && k < P.ph_hi) { if (k > P.ph_lo) grid.sync(); run_phase<k>(P); }
    PH(0) PH(1) PH(2) PH(3) PH(4) PH(5) PH(6) PH(7) PH(8) PH(9) PH(10) PH(11) PH(12) PH(13) PH(14) PH(15) PH(16) PH(17) PH(18) PH(19)
#undef PH
}

extern "C" void kernel_launch(void* const* d_in, const int* in_sizes, int n_in, void* d_out, int out_size, void* d_ws, size_t ws_size,
                              hipStream_t stream) {
    static int grid_blocks = 0;
    if (!grid_blocks) {
        int dev = 0, cus = 0, per_cu = 0;
        hipGetDevice(&dev);
        hipDeviceGetAttribute(&cus, hipDeviceAttributeMultiprocessorCount, dev);
        hipFuncSetAttribute((const void*)yoco_fwd, hipFuncAttributeMaxDynamicSharedMemorySize, LDS_BYTES);
        hipOccupancyMaxActiveBlocksPerMultiprocessor(&per_cu, (const void*)yoco_fwd, NTHR, LDS_BYTES);
        if (per_cu < 1) per_cu = 1;
        grid_blocks = cus * per_cu;
        if (ws_size < WS_NEED || n_in != 40) { fprintf(stderr, "kernel_launch: ws_size %zu < %zu or n_in %d != 40\n", ws_size, (size_t)WS_NEED, n_in); grid_blocks = -1; }
    }
    if (grid_blocks < 0) return;
    Params p{};
    for (int i = 0; i < 40; ++i) p.in[i] = (const float*)d_in[i];
    p.out = (float*)d_out; p.ws = (unsigned char*)d_ws; p.ph_lo = 0; p.ph_hi = 20;
    void* args[] = {&p};
    hipError_t e = hipLaunchCooperativeKernel((const void*)yoco_fwd, dim3(grid_blocks), dim3(NTHR), args, LDS_BYTES, stream);
    if (e != hipSuccess) fprintf(stderr, "cooperative launch failed: %s (grid %d)\n", hipGetErrorString(e), grid_blocks);
}
```
